# Optimizing an MI355X kernel written in HIP

```python
import math
import jax, jax.numpy as jnp
from jax import lax
import numpy as np

D_MODEL = 1024
BATCH = 4
SEQ = 8192
DEPTH = 1

MEM_LEN = 256
BRANCH_WIDTH = D_MODEL // 2
POOL_WINDOWS = (2, 4, 8, 16)
POOL_GROUPS = len(POOL_WINDOWS)
POOL_GROUP_DIM = BRANCH_WIDTH // POOL_GROUPS
DIFF_HEADS = 8
DIFF_QK_DIM = D_MODEL // 32
DIFF_V_DIM = 2 * DIFF_QK_DIM
DIFF_QK_WIDTH = DIFF_HEADS * 2 * DIFF_QK_DIM
MEM_HEADS = 4
MEM_HEAD_DIM = BRANCH_WIDTH // MEM_HEADS
N_BRANCH = 3
Q_BLOCK = 128
LN_EPS = 1e-5
RMS_EPS = 1e-5
DEEPNORM_ALPHA = (2.0 * DEPTH) ** 0.25
DEEPNORM_BETA = (8.0 * DEPTH) ** -0.25
IN_WIDTHS = (BRANCH_WIDTH, BRANCH_WIDTH,
             DIFF_QK_WIDTH, DIFF_QK_WIDTH,
             BRANCH_WIDTH, BRANCH_WIDTH,
             BRANCH_WIDTH, BRANCH_WIDTH,
             N_BRANCH * D_MODEL)
IN_TOTAL = sum(IN_WIDTHS)

kernel_name = "hybrid_pool_diffattn_memxattn_deepnorm"


def layer_norm(x, g, b):
    xf = x.astype(jnp.float32)
    mu = jnp.mean(xf, axis=-1, keepdims=True)
    var = jnp.mean(jnp.square(xf - mu), axis=-1, keepdims=True)
    y = (xf - mu) * lax.rsqrt(var + LN_EPS) * g.astype(jnp.float32) + b.astype(jnp.float32)
    return y.astype(x.dtype)


def rms_norm(x, g):
    xf = x.astype(jnp.float32)
    y = xf * lax.rsqrt(jnp.mean(jnp.square(xf), axis=-1, keepdims=True) + RMS_EPS)
    return (y * g.astype(jnp.float32)).astype(x.dtype)


def lambda_init_fn(layer_idx):
    return 0.8 - 0.6 * math.exp(-0.3 * layer_idx)


def alibi_slopes(n_heads):
    return jnp.array([2.0 ** (-8.0 * (h + 1) / n_heads) for h in range(n_heads)], dtype=jnp.float32)


def causal_multiscale_pool(u):
    b, s, _, c = u.shape
    t_count = jnp.arange(1, s + 1, dtype=jnp.float32)
    outs = []
    for g, w in enumerate(POOL_WINDOWS):
        ug = u[:, :, g, :].astype(jnp.float32)
        csum = jnp.concatenate([jnp.zeros((b, 1, c), jnp.float32), jnp.cumsum(ug, axis=1)], axis=1)
        upper = csum[:, 1:]
        lower = jnp.concatenate([jnp.zeros((b, w - 1, c), jnp.float32), csum[:, : s - w + 1]], axis=1)
        count = jnp.minimum(t_count, float(w))[None, :, None]
        outs.append((upper - lower) / count - ug)
    return jnp.stack(outs, axis=2).astype(u.dtype)


def differential_attention(q, k, v, lam):
    b, s, h, _, dq = q.shape
    n_blk = s // Q_BLOCK
    scale = dq ** -0.5
    slopes = alibi_slopes(h)
    k_pos = jnp.arange(s)
    q_blocks = q.reshape(b, n_blk, Q_BLOCK, h, 2, dq).transpose(1, 0, 2, 3, 4, 5)

    def one_block(args):
        q_blk, i = args
        q_pos = i * Q_BLOCK + jnp.arange(Q_BLOCK)
        sc = jnp.einsum('bqhcd,bkhcd->bhcqk', q_blk, k,
                        preferred_element_type=jnp.float32) * scale
        dist = q_pos[:, None] - k_pos[None, :]
        bias = -slopes[:, None, None] * dist.astype(jnp.float32)[None]
        sc = jnp.where((dist >= 0)[None, None, None], sc + bias[None, :, None], -jnp.inf)
        p = jax.nn.softmax(sc, axis=-1)
        a = p[:, :, 0] - lam * p[:, :, 1]
        return jnp.einsum('bhqk,bkhe->bqhe', a.astype(v.dtype), v)

    out = lax.map(one_block, (q_blocks, jnp.arange(n_blk)))
    return out.transpose(1, 0, 2, 3, 4).reshape(b, s, h, v.shape[-1])


def memory_cross_attention(q, mk, mv):
    scale = q.shape[-1] ** -0.5
    sc = jnp.einsum('bshd,bmhd->bhsm', q, mk, preferred_element_type=jnp.float32) * scale
    p = jax.nn.softmax(sc, axis=-1)
    return jnp.einsum('bhsm,bmhd->bshd', p.astype(mv.dtype), mv)


def hybrid_layer(x, mem, layer_idx, w_in, b_gate, pool_w, pool_scale, lambda_q1, lambda_k1,
                 lambda_q2, lambda_k2, diff_norm_g, w_mem_kv, w_branch, w_out, ln_out_g, ln_out_b):
    b, s, d = x.shape
    proj = jnp.einsum('bsd,de->bse', x, w_in)
    offs = [0]
    for wdt in IN_WIDTHS:
        offs.append(offs[-1] + wdt)
    parts = [proj[..., offs[i]:offs[i + 1]] for i in range(len(IN_WIDTHS))]
    pool_u, pool_z, dq_, dk_, dv_, diff_z, mq_, mem_z, gates = parts

    u = pool_u.reshape(b, s, POOL_GROUPS, POOL_GROUP_DIM)
    pooled = causal_multiscale_pool(u)
    pooled = jnp.einsum('bsgc,gce->bsge', pooled, pool_w).reshape(b, s, BRANCH_WIDTH) * pool_scale
    o_pool = pooled * jax.nn.silu(pool_z)

    lam_init = lambda_init_fn(layer_idx)
    lam = (jnp.exp(jnp.sum(lambda_q1.astype(jnp.float32) * lambda_k1.astype(jnp.float32)))
           - jnp.exp(jnp.sum(lambda_q2.astype(jnp.float32) * lambda_k2.astype(jnp.float32)))
           + lam_init)
    q = dq_.reshape(b, s, DIFF_HEADS, 2, DIFF_QK_DIM)
    k = dk_.reshape(b, s, DIFF_HEADS, 2, DIFF_QK_DIM)
    v = dv_.reshape(b, s, DIFF_HEADS, DIFF_V_DIM)
    att = differential_attention(q, k, v, lam)
    att = rms_norm(att, diff_norm_g) * (1.0 - lam_init)
    o_diff = att.reshape(b, s, BRANCH_WIDTH) * jax.nn.silu(diff_z)

    mkv = jnp.einsum('bmd,de->bme', mem, w_mem_kv)
    mk = mkv[..., :BRANCH_WIDTH].reshape(b, MEM_LEN, MEM_HEADS, MEM_HEAD_DIM)
    mv = mkv[..., BRANCH_WIDTH:].reshape(b, MEM_LEN, MEM_HEADS, MEM_HEAD_DIM)
    mq = mq_.reshape(b, s, MEM_HEADS, MEM_HEAD_DIM)
    o_mem = memory_cross_attention(mq, mk, mv).reshape(b, s, BRANCH_WIDTH) * jax.nn.silu(mem_z)

    o = jnp.stack([o_pool, o_diff, o_mem], axis=2)
    y = jnp.einsum('bsnc,ncd->bsnd', o, w_branch)
    g = jax.nn.sigmoid((gates + b_gate).reshape(b, s, N_BRANCH, d))
    merged = jnp.sum(g * y, axis=2)
    out = jnp.einsum('bsd,de->bse', merged, w_out)
    return layer_norm(DEEPNORM_ALPHA * x + out, ln_out_g, ln_out_b)


def setup_inputs(seed: int = 0) -> dict:
    key = jax.random.key(seed)
    ks = jax.random.split(key, 20)
    f32 = jnp.float32
    d = D_MODEL
    beta = DEEPNORM_BETA
    seg_scale = (beta, 1.0, 1.0, 1.0, beta, 1.0, 1.0, 1.0, 1.0)
    col_scale = jnp.concatenate([jnp.full((wdt,), sc, f32) for wdt, sc in zip(IN_WIDTHS, seg_scale)])
    w_in = jax.random.normal(ks[2], (DEPTH, d, IN_TOTAL), f32) * (d ** -0.5) * col_scale
    kv_scale = jnp.concatenate([jnp.ones((BRANCH_WIDTH,), f32), jnp.full((BRANCH_WIDTH,), beta, f32)])
    w_mem_kv = jax.random.normal(ks[3], (DEPTH, d, 2 * BRANCH_WIDTH), f32) * (d ** -0.5) * kv_scale
    return {
        "x": jax.random.normal(ks[0], (BATCH, SEQ, d), f32),
        "mem": jax.random.normal(ks[1], (BATCH, MEM_LEN, d), f32),
        "ln_in_g": 1.0 + 0.02 * jax.random.normal(ks[4], (d,), f32),
        "ln_in_b": 0.02 * jax.random.normal(ks[5], (d,), f32),
        "w_in": w_in,
        "b_gate": 0.01 * jax.random.normal(ks[6], (DEPTH, N_BRANCH * d), f32),
        "pool_w": jax.random.normal(ks[7], (DEPTH, POOL_GROUPS, POOL_GROUP_DIM, POOL_GROUP_DIM), f32) * (POOL_GROUP_DIM ** -0.5),
        "pool_scale": 1.0 + 0.02 * jax.random.normal(ks[8], (DEPTH, BRANCH_WIDTH), f32),
        "lambda_q1": 0.1 * jax.random.normal(ks[9], (DEPTH, DIFF_QK_DIM), f32),
        "lambda_k1": 0.1 * jax.random.normal(ks[10], (DEPTH, DIFF_QK_DIM), f32),
        "lambda_q2": 0.1 * jax.random.normal(ks[11], (DEPTH, DIFF_QK_DIM), f32),
        "lambda_k2": 0.1 * jax.random.normal(ks[12], (DEPTH, DIFF_QK_DIM), f32),
        "diff_norm_g": 1.0 + 0.02 * jax.random.normal(ks[13], (DEPTH, DIFF_V_DIM), f32),
        "w_mem_kv": w_mem_kv,
        "w_branch": jax.random.normal(ks[14], (DEPTH, N_BRANCH, BRANCH_WIDTH, d), f32) * (BRANCH_WIDTH ** -0.5) * beta,
        "w_out": jax.random.normal(ks[15], (DEPTH, d, d), f32) * (d ** -0.5) * beta,
        "ln_out_g": 1.0 + 0.02 * jax.random.normal(ks[16], (DEPTH, d), f32),
        "ln_out_b": 0.02 * jax.random.normal(ks[17], (DEPTH, d), f32),
    }


def reference(x, mem, ln_in_g, ln_in_b, w_in, b_gate, pool_w, pool_scale, lambda_q1, lambda_k1,
              lambda_q2, lambda_k2, diff_norm_g, w_mem_kv, w_branch, w_out, ln_out_g, ln_out_b):
    h = layer_norm(x, ln_in_g, ln_in_b)
    for l in range(DEPTH):
        h = hybrid_layer(h, mem, l, w_in[l], b_gate[l], pool_w[l], pool_scale[l],
                         lambda_q1[l], lambda_k1[l], lambda_q2[l], lambda_k2[l], diff_norm_g[l],
                         w_mem_kv[l], w_branch[l], w_out[l], ln_out_g[l], ln_out_b[l])
    return h
```

```cpp
#include <hip/hip_runtime.h>
#include <hip/hip_bf16.h>
#include <cstdio>
#include <cstdint>
#include <cmath>

constexpr int BATCH = 4, SEQ = 8192, DMODEL = 1024, MROWS = BATCH * SEQ;
constexpr int MEMLEN = 256, BW = 512, NPROJ = 4096, NGATE = 3072, NIN = NPROJ + NGATE;
constexpr int NHEAD = 8, MHEADS = 4;
constexpr float LN_EPS = 1e-5f, RMS_EPS = 1e-5f;
constexpr float DN_ALPHA = 1.189207115002721f;
constexpr float LAM_INIT = 0.2f;
constexpr float LOG2E = 1.4426950408889634f;
constexpr float QSCALE = 0.17677669529663687f * LOG2E;
constexpr float MQSCALE = 0.08838834764831845f * LOG2E;

namespace pg8 {
#define PG8_LAS __attribute__((address_space(3)))
typedef unsigned short bf16_t;
typedef short bf16x8 __attribute__((ext_vector_type(8)));
typedef float f32x4 __attribute__((ext_vector_type(4)));
typedef unsigned u32x4 __attribute__((ext_vector_type(4)));
constexpr int BM = 256, BK = 64, HALF = 128, HTB = HALF * BK * 2  , STAGE_BYTES = 8 * HTB, NXCD = 8, WGM = 8;

__host__ __device__ __forceinline__ int lds_byte(int r, int c) { const int st = (r >> 4) * 2 + (c >> 5), rr = r & 15, cc = c & 31, ob = rr * 64 + cc * 2; return st * 1024 + (ob ^ (((ob >> 9) & 1) << 5)); }
__host__ __device__ __forceinline__ void stage_rc(int b, int& R, int& C) { const int st = b / 1024, sb = b % 1024, swz = sb ^ (((sb >> 9) & 1) << 5); R = (st >> 1) * 16 + swz / 64; C = (st & 1) * 32 + (swz % 64) / 2; }
__host__ __device__ __forceinline__ int perm32(int rho) { const int n = rho >> 4, i = rho & 15; return 8 * (i >> 2) + 4 * n + (i & 3); }


struct Unit { int pm, pn, z; };
struct Gemm { const bf16_t* A; const bf16_t* Bt; size_t zsA, zsB; int M, N, K;
    __device__ __forceinline__ const char* a_ptr(const Unit& u) const { return (const char*)(A + (size_t)u.z * zsA) + (size_t)u.pm * (size_t)(BM * 2) * (size_t)K; }
    __device__ __forceinline__ const char* b_ptr(const Unit& u) const { return (const char*)(Bt + (size_t)u.z * zsB) + (size_t)u.pn * (size_t)(BM * 2) * (size_t)K; }
};

template <int NZ> struct StaticOrderZ {
    int nM, nN, nwg, G, c;
    __host__ __device__ void init(int M, int N, int G_, int c_) { nM = M / BM; nN = N / BM; nwg = nM * nN; G = G_; c = c_; }
    __host__ __device__ bool next(int i, Unit& u) const {
        const int it = i / NZ; u.z = i - it * NZ;
        const long L = (long)it * G + c; if (L >= nwg) return false;
        int wgid = (int)L; { const int q = nwg / NXCD, r = nwg % NXCD, xcd = wgid % NXCD, off = wgid / NXCD; wgid = (xcd < r ? xcd * (q + 1) : r * (q + 1) + (xcd - r) * q) + off; }
        const int nig = WGM * nN, gid = wgid / nig, fm = gid * WGM, gsz = (nM - fm) < WGM ? (nM - fm) : WGM;
        u.pm = fm + ((wgid % nig) % gsz); u.pn = (wgid % nig) / gsz; return true;
    }
    __device__ __forceinline__ void a_ready(const Unit&) const {}
    __device__ __forceinline__ void done(const Unit&) const {}
};
typedef StaticOrderZ<1> StaticOrder;

typedef float f32x2_c __attribute__((ext_vector_type(2))); typedef __bf16 bf16x2_c __attribute__((ext_vector_type(2)));
__device__ __forceinline__ unsigned cvt_pk_bf16(float lo, float hi) { f32x2_c v = {lo, hi}; bf16x2_c b = __builtin_convertvector(v, bf16x2_c); return __builtin_bit_cast(unsigned, b); }
__device__ __forceinline__ float bf_lo(unsigned u) { return __uint_as_float(u << 16); }
__device__ __forceinline__ float bf_hi(unsigned u) { return __uint_as_float(u & 0xffff0000u); }
__device__ __forceinline__ float sigmoid_f(float v) { return __builtin_amdgcn_rcpf(1.0f + __builtin_amdgcn_exp2f(-1.4426950408889634f * v)); }

struct EpiBf16 {
    static constexpr bool PERM = true, AFTER_DRAIN = false;
    bf16_t* O; int ldc;
    __device__ __forceinline__ void operator()(const f32x4 (&acc)[2][2][4][2], const Unit& u, int wr, int wc, int fr, int fq) const {
        const int row0 = u.pm * BM + wr * 64 + fr, col0 = u.pn * BM + wc * 32 + 8 * fq;
#pragma unroll
        for (int ai = 0; ai < 2; ++ai)
#pragma unroll
            for (int m = 0; m < 4; ++m) { bf16_t* rowp = O + (size_t)(row0 + ai * HALF + m * 16) * ldc + col0;
#pragma unroll
                for (int bj = 0; bj < 2; ++bj) { const f32x4 v0 = acc[ai][bj][m][0], v1 = acc[ai][bj][m][1];
                    u32x4 w; w.x = cvt_pk_bf16(v0[0], v0[1]); w.y = cvt_pk_bf16(v0[2], v0[3]); w.z = cvt_pk_bf16(v1[0], v1[1]); w.w = cvt_pk_bf16(v1[2], v1[3]);
                    *(u32x4*)(rowp + bj * HALF) = w; } }
    }
};

struct EpiProj {
    static constexpr bool PERM = true, AFTER_DRAIN = false;
    bf16_t* proj; bf16_t* G; const float* b_gate; int mrows;
    template <int MODE> __device__ __forceinline__ void run(const f32x4 (&acc)[2][2][4][2], bf16_t* base, int ldc, int row0, int col0, float sc, const float* bias) const {
        f32x4 bv[2][2];
#pragma unroll
        for (int bj = 0; bj < 2; ++bj)
#pragma unroll
            for (int n = 0; n < 2; ++n) bv[bj][n] = (MODE == 2) ? *(const f32x4*)(bias + bj * HALF + 4 * n) : (f32x4){0.f, 0.f, 0.f, 0.f};
#pragma unroll
        for (int ai = 0; ai < 2; ++ai)
#pragma unroll
            for (int m = 0; m < 4; ++m) { bf16_t* rowp = base + (size_t)(row0 + ai * HALF + m * 16) * ldc + col0;
#pragma unroll
                for (int bj = 0; bj < 2; ++bj) { f32x4 v0 = acc[ai][bj][m][0], v1 = acc[ai][bj][m][1];
                    if (MODE == 0) { v0 = v0 * sc; v1 = v1 * sc; }
                    if (MODE == 1) {
#pragma unroll
                        for (int e = 0; e < 4; ++e) { v0[e] = v0[e] * sigmoid_f(v0[e]); v1[e] = v1[e] * sigmoid_f(v1[e]); } }
                    if (MODE == 2) {
#ifdef DBG_NOACC
                        v0 = (f32x4){0.f, 0.f, 0.f, 0.f}; v1 = v0;
#endif
#ifdef DBG_CLAMPBIAS
                        for (int e = 0; e < 4; ++e) { v0[e] += fminf(fmaxf(bv[bj][0][e], -0.05f), 0.05f); v1[e] += fminf(fmaxf(bv[bj][1][e], -0.05f), 0.05f); }
#elif !defined(DBG_NOBIAS)
                        v0 = v0 + bv[bj][0]; v1 = v1 + bv[bj][1];
#endif

#pragma unroll
                        for (int e = 0; e < 4; ++e) { v0[e] = sigmoid_f(v0[e]); v1[e] = sigmoid_f(v1[e]); } }
                    u32x4 w; w.x = cvt_pk_bf16(v0[0], v0[1]); w.y = cvt_pk_bf16(v0[2], v0[3]); w.z = cvt_pk_bf16(v1[0], v1[1]); w.w = cvt_pk_bf16(v1[2], v1[3]);
                    *(u32x4*)(rowp + bj * HALF) = w; } }
    }
    __device__ __forceinline__ void operator()(const f32x4 (&acc)[2][2][4][2], const Unit& u, int wr, int wc, int fr, int fq) const {
        const int row0 = u.pm * BM + wr * 64 + fr, colt = u.pn * BM, cw = wc * 32 + 8 * fq;
        if (colt < 4096) { const int seg = colt >> 9, slot = (0x73654210u >> (4 * seg)) & 7; bf16_t* base = proj + (size_t)slot * (size_t)mrows * 512; const int col0 = (colt & 511) + cw;
            if (seg == 1 || seg == 5 || seg == 7) run<1>(acc, base, 512, row0, col0, 1.f, nullptr);
            else run<0>(acc, base, 512, row0, col0, seg == 2 ? 0.25503486f   : (seg == 6 ? 0.12751743f   : 1.f), nullptr); }
        else { const int col0 = colt - 4096 + cw; run<2>(acc, G, 3072, row0, col0, 1.f, b_gate + col0); }
    }
};

struct EpiMerge {
    static constexpr bool PERM = true, AFTER_DRAIN = false;
    const bf16_t* G; bf16_t* MG;
    __device__ __forceinline__ void operator()(const f32x4 (&acc)[2][2][4][2], const Unit& u, int wr, int wc, int fr, int fq) const {
        const int row0 = u.pm * BM + wr * 64 + fr, col0 = u.pn * BM + wc * 32 + 8 * fq; const int z = u.z;
#pragma unroll
        for (int ai = 0; ai < 2; ++ai)
#pragma unroll
            for (int m = 0; m < 4; ++m) { const size_t row = (size_t)(row0 + ai * HALF + m * 16);
#ifdef DBG_GROT
                const bf16_t* gp = G + row * 3072 + (size_t)((z + DBG_GROT) % 3) * 1024 + col0;
#else
                const bf16_t* gp = G + row * 3072 + (size_t)z * 1024 + col0;
#endif
                bf16_t* mp = MG + row * 1024 + col0;
#pragma unroll
                for (int bj = 0; bj < 2; ++bj) { const f32x4 v0 = acc[ai][bj][m][0], v1 = acc[ai][bj][m][1]; u32x4 g = *(const u32x4*)(gp + bj * HALF);
#ifdef DBG_GHALF
                    g = (u32x4){0x3f003f00u, 0x3f003f00u, 0x3f003f00u, 0x3f003f00u};
#endif

                    float r0 = bf_lo(g.x) * v0[0], r1 = bf_hi(g.x) * v0[1], r2 = bf_lo(g.y) * v0[2], r3 = bf_hi(g.y) * v0[3];
                    float r4 = bf_lo(g.z) * v1[0], r5 = bf_hi(g.z) * v1[1], r6 = bf_lo(g.w) * v1[2], r7 = bf_hi(g.w) * v1[3];
#ifdef DBG_ZERO_Z
                    if (z == DBG_ZERO_Z) { r0 = r1 = r2 = r3 = r4 = r5 = r6 = r7 = 0.f; }
#endif
                    if (z > 0) { const u32x4 p = *(const u32x4*)(mp + bj * HALF);
                        r0 += bf_lo(p.x); r1 += bf_hi(p.x); r2 += bf_lo(p.y); r3 += bf_hi(p.y); r4 += bf_lo(p.z); r5 += bf_hi(p.z); r6 += bf_lo(p.w); r7 += bf_hi(p.w); }
                    u32x4 w; w.x = cvt_pk_bf16(r0, r1); w.y = cvt_pk_bf16(r2, r3); w.z = cvt_pk_bf16(r4, r5); w.w = cvt_pk_bf16(r6, r7);
                    *(u32x4*)(mp + bj * HALF) = w; } }
    }
};

template <class Epi, class Sched, bool ALIGN_EPI = false, bool SP2 = false>
__device__ __forceinline__ void gemm_phase(PG8_LAS unsigned char* lds, const Gemm g, const Sched& S, const Epi& E) {
    const int tid = threadIdx.x, wid = __builtin_amdgcn_readfirstlane(tid >> 6), lane = tid & 63, wr = wid >> 2, wc = wid & 3, fr = lane & 15, fq = lane >> 4;
    const int K = g.K, nt = K / BK;
    unsigned voffA[2], voffB[2];
#pragma unroll
    for (int i = 0; i < 2; ++i) { int R, C; stage_rc(tid * 16 + i * 8192, R, C); const int Rb = Epi::PERM ? ((R & ~31) + perm32(R & 31)) : R;
        voffA[i] = (unsigned)(R * K + C) * 2u; voffB[i] = (unsigned)(Rb * K + C) * 2u; }
    const size_t kstep = (size_t)(BK * 2);
    const size_t hstep = (size_t)HALF * K * 2;
    const unsigned ldsw = (unsigned)wid * 1024u;
    const int aoff = lds_byte(wr * 64 + fr, fq * 8), boff = lds_byte(wc * 32 + fr, fq * 8);
#define PG8_SA(b, h) (((b) * 2 + (h)) * HTB)
#define PG8_SB(b, h) ((4 + (b) * 2 + (h)) * HTB)
#define PG8_STAGE(bufoff, gbase, voff) do { _Pragma("unroll") for (int _i = 0; _i < 2; ++_i) \
        __builtin_amdgcn_global_load_lds((const unsigned*)((const char*)(gbase) + (voff)[_i]), (PG8_LAS unsigned*)(lds + (bufoff) + ldsw + _i * 8192), 16, 0, 0); } while (0)
#define PG8_LDA(dst, b, h) do { _Pragma("unroll") for (int m = 0; m < 4; ++m) _Pragma("unroll") for (int k = 0; k < 2; ++k) dst[m][k] = *(const PG8_LAS bf16x8*)(lds + PG8_SA(b, h) + aoff + m * 2048 + k * 1024); } while (0)
#define PG8_LDB(dst, b, h) do { _Pragma("unroll") for (int n = 0; n < 2; ++n) _Pragma("unroll") for (int k = 0; k < 2; ++k) dst[n][k] = *(const PG8_LAS bf16x8*)(lds + PG8_SB(b, h) + boff + n * 2048 + k * 1024); } while (0)
#define PG8_MMA(ai, bj, At, Bt) do { __builtin_amdgcn_s_setprio(1); _Pragma("unroll") for (int m = 0; m < 4; ++m) _Pragma("unroll") for (int n = 0; n < 2; ++n) _Pragma("unroll") for (int k = 0; k < 2; ++k) \
        acc[ai][bj][m][n] = __builtin_amdgcn_mfma_f32_16x16x32_bf16(Bt[n][k], At[m][k], acc[ai][bj][m][n], 0, 0, 0); __builtin_amdgcn_s_setprio(0); } while (0)
#define PG8_WAIT_V(n) asm volatile("s_waitcnt vmcnt(" #n ")" ::: "memory")
#define PG8_WAIT_L(n) asm volatile("s_waitcnt lgkmcnt(" #n ")" ::: "memory")
#define PG8_BAR __builtin_amdgcn_s_barrier()
#define PG8_SCHED __builtin_amdgcn_sched_barrier(0)
    Unit cur, nxt; int ui = 0;
    if (!S.next(0, cur)) return;
    f32x4 acc[2][2][4][2];
#pragma unroll
    for (int a = 0; a < 2; ++a)
#pragma unroll
        for (int b = 0; b < 2; ++b)
#pragma unroll
            for (int m = 0; m < 4; ++m)
#pragma unroll
                for (int n = 0; n < 2; ++n) acc[a][b][m][n] = (f32x4){0.f, 0.f, 0.f, 0.f};
    bf16x8 At[4][2], B0[2][2], B1[2][2];
    const char* cA = g.a_ptr(cur); const char* cB = g.b_ptr(cur);
    S.a_ready(cur);
    if constexpr (SP2) {
        PG8_STAGE(PG8_SB(0, 0), cB, voffB); PG8_STAGE(PG8_SB(0, 1), cB + hstep, voffB); PG8_STAGE(PG8_SA(0, 0), cA, voffA); PG8_STAGE(PG8_SA(0, 1), cA + hstep, voffA);
        if (wr == 1) PG8_BAR;
        PG8_WAIT_V(2); PG8_BAR;
        PG8_STAGE(PG8_SB(1, 0), cB + kstep, voffB); PG8_STAGE(PG8_SA(1, 0), cA + kstep, voffA); PG8_STAGE(PG8_SB(1, 1), cB + hstep + kstep, voffB);
        PG8_WAIT_V(6); PG8_BAR;
    } else {
        PG8_STAGE(PG8_SB(0, 0), cB, voffB); PG8_STAGE(PG8_SA(0, 0), cA, voffA); PG8_STAGE(PG8_SB(0, 1), cB + hstep, voffB); PG8_STAGE(PG8_SA(0, 1), cA + hstep, voffA);
        if (wr == 1) PG8_BAR;
        PG8_WAIT_V(4); PG8_BAR;
        PG8_STAGE(PG8_SB(1, 0), cB + kstep, voffB); PG8_STAGE(PG8_SA(1, 0), cA + kstep, voffA); PG8_STAGE(PG8_SB(1, 1), cB + hstep + kstep, voffB);
        PG8_WAIT_V(6); PG8_BAR;
    }
    for (;;) {
        const bool has_next = S.next(ui + 1, nxt);
        const char* nA = has_next ? g.a_ptr(nxt) : cA; const char* nB = has_next ? g.b_ptr(nxt) : cB;
        for (int t = 0; t < nt; t += 2) {
            const bool last = (t == nt - 2);
            const char* a1 = cA + (size_t)(t + 1) * kstep;
            const char* a2 = last ? nA : cA + (size_t)(t + 2) * kstep; const char* b2 = last ? nB : cB + (size_t)(t + 2) * kstep;
            const char* a3 = a2 + kstep; const char* b3 = b2 + kstep;
            if (last && has_next) S.a_ready(nxt);
            if constexpr (SP2) {
            PG8_LDB(B0, 0, 0); PG8_LDB(B1, 0, 1); PG8_SCHED; PG8_LDA(At, 0, 0); PG8_STAGE(PG8_SA(1, 1), a1 + hstep, voffA);
            PG8_WAIT_V(8); PG8_WAIT_L(0); PG8_BAR; PG8_MMA(0, 0, At, B0); PG8_MMA(0, 1, At, B1); PG8_BAR; PG8_SCHED;
            PG8_LDA(At, 0, 1); PG8_STAGE(PG8_SB(0, 0), b2, voffB); PG8_STAGE(PG8_SB(0, 1), b2 + hstep, voffB); PG8_STAGE(PG8_SA(0, 0), a2, voffA);
            PG8_WAIT_V(8); PG8_WAIT_L(0); PG8_BAR; PG8_MMA(1, 0, At, B0); PG8_MMA(1, 1, At, B1); PG8_BAR; PG8_SCHED;
            PG8_LDB(B0, 1, 0); PG8_LDB(B1, 1, 1); PG8_SCHED; PG8_LDA(At, 1, 0); PG8_STAGE(PG8_SA(0, 1), a2 + hstep, voffA);
            PG8_WAIT_V(8); PG8_WAIT_L(0); PG8_BAR; PG8_MMA(0, 0, At, B0); PG8_MMA(0, 1, At, B1); PG8_BAR; PG8_SCHED;
            PG8_LDA(At, 1, 1); PG8_STAGE(PG8_SB(1, 0), b3, voffB); PG8_STAGE(PG8_SB(1, 1), b3 + hstep, voffB); PG8_STAGE(PG8_SA(1, 0), a3, voffA);
            PG8_WAIT_V(8); PG8_WAIT_L(0); PG8_BAR; PG8_MMA(1, 0, At, B0); PG8_MMA(1, 1, At, B1); PG8_BAR; PG8_SCHED;
            } else {
            PG8_LDB(B0, 0, 0); PG8_SCHED; PG8_LDA(At, 0, 0); PG8_STAGE(PG8_SA(1, 1), a1 + hstep, voffA);
            PG8_WAIT_L(8); PG8_BAR; PG8_WAIT_L(0); PG8_MMA(0, 0, At, B0); PG8_BAR; PG8_SCHED;
            PG8_LDB(B1, 0, 1); PG8_STAGE(PG8_SB(0, 0), b2, voffB);
            PG8_BAR; PG8_WAIT_L(0); PG8_MMA(0, 1, At, B1); PG8_BAR;
            PG8_LDA(At, 0, 1); PG8_STAGE(PG8_SA(0, 0), a2, voffA);
            PG8_BAR; PG8_WAIT_L(0); PG8_MMA(1, 0, At, B0); PG8_BAR; PG8_SCHED;
            PG8_STAGE(PG8_SB(0, 1), b2 + hstep, voffB);
            PG8_WAIT_V(6); PG8_BAR; PG8_MMA(1, 1, At, B1); PG8_BAR;
            PG8_LDB(B0, 1, 0); PG8_SCHED; PG8_LDA(At, 1, 0); PG8_STAGE(PG8_SA(0, 1), a2 + hstep, voffA);
            PG8_WAIT_L(8); PG8_BAR; PG8_WAIT_L(0); PG8_MMA(0, 0, At, B0); PG8_BAR; PG8_SCHED;
            PG8_LDB(B1, 1, 1); PG8_STAGE(PG8_SB(1, 0), b3, voffB);
            PG8_BAR; PG8_WAIT_L(0); PG8_MMA(0, 1, At, B1); PG8_BAR;
            PG8_LDA(At, 1, 1); PG8_STAGE(PG8_SA(1, 0), a3, voffA);
            PG8_BAR; PG8_WAIT_L(0); PG8_MMA(1, 0, At, B0); PG8_BAR; PG8_SCHED;
            PG8_STAGE(PG8_SB(1, 1), b3 + hstep, voffB);
            PG8_WAIT_V(6); PG8_BAR; PG8_MMA(1, 1, At, B1); PG8_BAR;
            }
        }
        if constexpr (ALIGN_EPI) { if (wr == 0) PG8_BAR; }
        if constexpr (!Epi::AFTER_DRAIN) { E(acc, cur, wr, wc, fr, fq); S.done(cur); }
        if (!has_next) break;
#pragma unroll
        for (int a = 0; a < 2; ++a)
#pragma unroll
            for (int b = 0; b < 2; ++b)
#pragma unroll
                for (int m = 0; m < 4; ++m)
#pragma unroll
                    for (int n = 0; n < 2; ++n) acc[a][b][m][n] = (f32x4){0.f, 0.f, 0.f, 0.f};
        cur = nxt; cA = nA; cB = nB; ++ui;
        if constexpr (ALIGN_EPI) { if (wr == 1) PG8_BAR; }
    }
    PG8_WAIT_V(0);
    if constexpr (!ALIGN_EPI) { if (wr == 0) PG8_BAR; }
    PG8_BAR;
    if constexpr (Epi::AFTER_DRAIN) { E.fused(acc, cur, wr, wc, fr, fq, lds, wid, lane); S.done(cur); }
#undef PG8_SA
#undef PG8_SB
#undef PG8_STAGE
#undef PG8_LDA
#undef PG8_LDB
#undef PG8_MMA
#undef PG8_WAIT_V
#undef PG8_WAIT_L
#undef PG8_BAR
#undef PG8_SCHED
}
}

#ifndef PG8_SP2
#define PG8_SP2 true
#endif
#ifndef PG8_ALIGN
#define PG8_ALIGN true
#endif
namespace dattn {
using bf16=__hip_bfloat16;
using bf16x8=__attribute__((ext_vector_type(8)))short;
using s16x4=__attribute__((ext_vector_type(4)))short;
using f32x16=__attribute__((ext_vector_type(16)))float;
using u32x4=__attribute__((ext_vector_type(4)))unsigned;
constexpr int DM=512;
constexpr int NW=8,QBLK=32,QB=QBLK*NW,KVBLK=64;
constexpr int SLABP=1024;
__device__ __forceinline__ int crow(int r,int hi){return (r&3)+8*(r>>2)+4*hi;}
#define SBAR() __builtin_amdgcn_sched_barrier(0)
__device__ __forceinline__ void cmask(f32x16&p0,f32x16&p1,int jb,int qrel,int hi){
  const float NEG=-INFINITY; int kb=64*jb+4*hi;
  #pragma unroll
  for(int r=0;r<16;++r){int kv=kb+(r&3)+8*(r>>2); if(kv>qrel)p0[r]=NEG; if(kv+32>qrel)p1[r]=NEG;}
}
constexpr int NSLOT=3, SLOTB=8192;
constexpr int LDS_K=0, LDS_V=NSLOT*SLOTB, LDS_WS=2*NSLOT*SLOTB, LDS_OST=LDS_WS+NW*64*4, LDS_BYTES=LDS_OST+NW*4096;
__device__ __forceinline__ void glds16(const void*gsrc,unsigned lds_dst){unsigned keep;
  asm volatile("s_mov_b32 %0, m0\n\ts_mov_b32 m0, %2\n\ts_nop 0\n\tglobal_load_lds_dwordx4 %1, off\n\ts_mov_b32 m0, %0":"=&s"(keep):"v"(gsrc),"s"(lds_dst):"memory");}
typedef float f32x2_t __attribute__((ext_vector_type(2))); typedef __bf16 bf16x2_t __attribute__((ext_vector_type(2)));
__device__ __forceinline__ unsigned cvtpk_s(float lo,float hi){f32x2_t v={lo,hi};bf16x2_t b=__builtin_convertvector(v,bf16x2_t);return __builtin_bit_cast(unsigned,b);}
#define WAIT_BAR(N) asm volatile("s_waitcnt vmcnt(" #N ") lgkmcnt(0)\n\ts_barrier":::"memory")
typedef __attribute__((address_space(3))) const char* lds_cptr;
typedef short v4i16_t __attribute__((ext_vector_type(4)));
__device__ __forceinline__ void kload2(bf16x8*kf,lds_cptr kp,int j){ kf[2*j]=*(const __attribute__((address_space(3))) bf16x8*)(kp+j*2048); kf[2*j+1]=*(const __attribute__((address_space(3))) bf16x8*)(kp+j*2048+512); }
__device__ __forceinline__ s16x4 vtr(lds_cptr p){ return __builtin_bit_cast(s16x4,__builtin_amdgcn_ds_read_tr16_b64_v4i16((__attribute__((address_space(3))) v4i16_t*)p)); }
#define MX3(a,b,c) __builtin_fmaxf(__builtin_fmaxf((a),(b)),(c))
__device__ __forceinline__ void pv(f32x16*o,int vb,bf16x8 pa0,bf16x8 pa1,bf16x8 pa2,bf16x8 pa3){
  #pragma unroll
  for(int d0=0;d0<2;++d0){s16x4 lo[4],hi[4];
    #pragma unroll
    for(int ks=0;ks<4;++ks){
      asm volatile("ds_read_b64_tr_b16 %0,%1 offset:%c2":"=&v"(lo[ks]):"v"(vb),"i"(d0*4096+ks*1024):"memory");
      asm volatile("ds_read_b64_tr_b16 %0,%1 offset:%c2":"=&v"(hi[ks]):"v"(vb),"i"(d0*4096+ks*1024+512):"memory");}
    asm volatile("s_waitcnt lgkmcnt(0)":::"memory");SBAR();
    #define PK(k) (bf16x8){lo[k][0],lo[k][1],lo[k][2],lo[k][3],hi[k][0],hi[k][1],hi[k][2],hi[k][3]}
    o[d0]=__builtin_amdgcn_mfma_f32_32x32x16_bf16(pa0,PK(0),o[d0],0,0,0);
    o[d0]=__builtin_amdgcn_mfma_f32_32x32x16_bf16(pa1,PK(1),o[d0],0,0,0);
    o[d0]=__builtin_amdgcn_mfma_f32_32x32x16_bf16(pa2,PK(2),o[d0],0,0,0);
    o[d0]=__builtin_amdgcn_mfma_f32_32x32x16_bf16(pa3,PK(3),o[d0],0,0,0);
    #undef PK
  }
}

template<int THRL> __device__ __forceinline__ void attn_unit(int b,int h,int c,int qb,const bf16*Q,const bf16*__restrict__ K,const bf16*__restrict__ V,bf16*SLAB,char*shm,float slope2){
  const int tid=threadIdx.x,lane=tid&63,r32=lane&31,hi=lane>>5; const int wid=__builtin_amdgcn_readfirstlane(tid>>6);
  const long rowbase=(long)b*SEQ; const int q0=qb*QB;
  const bf16*Qw=Q+(rowbase+q0+wid*QBLK)*DM+h*64+c*32;
  const bf16*Kh=K+rowbase*DM+h*64,*Vh=V+rowbase*DM+h*64;
  const unsigned lds0=(unsigned)(uintptr_t)shm;
  float*wsf=(float*)(shm+LDS_WS)+wid*64;
  const bf16*ksrc=Kh+(long)lane*DM+wid*8;
  const bf16*vsrc=Vh+(long)(16*(wid&3)+(lane>>2))*DM+(wid>>2)*32+(lane&3)*8;
  const unsigned kdst=lds0+LDS_K+wid*1024, vdst=lds0+LDS_V+wid*1024;
  #define DMA_K(t,slot) glds16(ksrc+(long)(t)*KVBLK*DM,(unsigned)__builtin_amdgcn_readfirstlane(kdst+(slot)))
  #define DMA_V(t,slot) glds16(vsrc+(long)(t)*KVBLK*DM,(unsigned)__builtin_amdgcn_readfirstlane(vdst+(slot)))
  const int vb0=(int)(lds0+LDS_V)+((lane>>4)&1)*32+(lane&3)*8+(4*hi+((lane&15)>>2))*64;
  bf16x8 kf[4];
  const lds_cptr shm3=(lds_cptr)shm; const lds_cptr kp0=shm3+LDS_K+hi*1024+r32*16+c*4096; const lds_cptr vp0=shm3+LDS_V+((lane>>4)&1)*32+(lane&3)*8+(4*hi+((lane&15)>>2))*64;
  const int NT=(q0+QB)/KVBLK;
  DMA_K(0,0);DMA_V(0,0);DMA_K(1,SLOTB);
  bf16x8 qr[2];
  #pragma unroll
  for(int d0=0;d0<2;++d0)qr[d0]=*reinterpret_cast<const bf16x8*>(&Qw[(long)r32*DM+d0*16+hi*8]);
  const int qrel=wid*QBLK+r32; const int qoff=q0+qrel;
  float mhat;
  { const bf16*kd=Kh+(long)qoff*DM+c*32+hi*16; const bf16x8 ka=*reinterpret_cast<const bf16x8*>(kd), kb=*reinterpret_cast<const bf16x8*>(kd+8);
    const bf16x8 qa=*reinterpret_cast<const bf16x8*>(&Qw[(long)r32*DM+hi*16]), qb2=*reinterpret_cast<const bf16x8*>(&Qw[(long)r32*DM+hi*16+8]);
    float s=0.f;
    #pragma unroll
    for(int j=0;j<8;++j){ s+=__uint_as_float(((unsigned)(unsigned short)ka[j])<<16)*__uint_as_float(((unsigned)(unsigned short)qa[j])<<16); s+=__uint_as_float(((unsigned)(unsigned short)kb[j])<<16)*__uint_as_float(((unsigned)(unsigned short)qb2[j])<<16); }
    auto rr=__builtin_amdgcn_permlane32_swap(__float_as_uint(s),__float_as_uint(s),false,false); mhat=__uint_as_float(rr[0])+__uint_as_float(rr[1]); }
  float l_reg=0.f;f32x16 o[2];o[0]=f32x16{};o[1]=f32x16{};
  f32x16 nA,nB;
  #define CMASK(P0,P1,t) do{int jb_=(t)-(NT-4); if(jb_>=0)cmask(P0,P1,jb_,qrel,hi);}while(0)
  #define MKBIAS_A(t) do{ const float bA_=__builtin_fmaf(slope2,(float)(64*(t)+4*hi-qoff),-mhat); \
      _Pragma("unroll") for(int r=0;r<16;++r){ nA[r]=__builtin_fmaf(slope2,(float)((r&3)+8*(r>>2)),bA_); } }while(0)
  #define MKBIAS_B(t) do{ const float bA_=__builtin_fmaf(slope2,(float)(64*(t)+4*hi-qoff),-mhat); \
      _Pragma("unroll") for(int r=0;r<16;++r){ nB[r]=__builtin_fmaf(slope2,(float)((r&3)+8*(r>>2)+32),bA_); } }while(0)
  bool resc=false;
  #define DECIDE(C0,C1) do{ float a=MX3(C0[0],C0[1],C1[0]),b_=MX3(C0[2],C0[3],C1[1]); a=MX3(a,C1[2],C1[3]); \
      _Pragma("unroll") for(int r=4;r<16;r+=4){a=MX3(a,C0[r],C0[r+1]);b_=MX3(b_,C0[r+2],C0[r+3]);a=MX3(a,C1[r],C1[r+1]);b_=MX3(b_,C1[r+2],C1[r+3]);} \
      float rm=__builtin_fmaxf(a,b_); { auto rr=__builtin_amdgcn_permlane32_swap(__float_as_uint(rm),__float_as_uint(rm),false,false); rm=__builtin_fmaxf(__uint_as_float(rr[0]),__uint_as_float(rr[1])); } \
      resc=false; \
      if(__builtin_expect(__any(rm>(float)THRL),0)){ const float dl=__builtin_fmaxf(rm,0.f); mhat+=dl; \
        _Pragma("unroll") for(int r=0;r<16;++r){C0[r]-=dl;C1[r]-=dl;} \
        const float f=__builtin_amdgcn_exp2f(-dl); l_reg*=f; if(hi==0)wsf[r32]=f; resc=true; } }while(0)
  #define RESC() do{ if(resc){ asm volatile("s_waitcnt lgkmcnt(0)":::"memory"); \
      _Pragma("unroll") for(int d_=0;d_<2;++d_) _Pragma("unroll") for(int r=0;r<16;++r)o[d_][r]*=wsf[crow(r,hi)]; } }while(0)
  f32x16 pA0,pA1,pB0,pB1;
  int sl_prev=0,sl_cur=0,sl_next=SLOTB;
  #define ROT() do{sl_prev=sl_cur;sl_cur=sl_next;sl_next=(sl_next==(NSLOT-1)*SLOTB)?0:sl_next+SLOTB;}while(0)
  DMA_K(2,2*SLOTB);
  WAIT_BAR(3);
  MKBIAS_A(0); MKBIAS_B(0);
  kload2(kf,kp0,0); kload2(kf,kp0,1);
  pA0=__builtin_amdgcn_mfma_f32_32x32x16_bf16(kf[0],qr[0],nA,0,0,0); pA1=__builtin_amdgcn_mfma_f32_32x32x16_bf16(kf[1],qr[0],nB,0,0,0);
  pA0=__builtin_amdgcn_mfma_f32_32x32x16_bf16(kf[2],qr[1],pA0,0,0,0); pA1=__builtin_amdgcn_mfma_f32_32x32x16_bf16(kf[3],qr[1],pA1,0,0,0);
  CMASK(pA0,pA1,0);
  DECIDE(pA0,pA1); resc=false;
  _Pragma("unroll") for(int r=0;r<16;++r){pA0[r]=__builtin_amdgcn_exp2f(pA0[r]);pA1[r]=__builtin_amdgcn_exp2f(pA1[r]);}
  WAIT_BAR(0);
  DMA_K(3,0);DMA_V(1,SLOTB);
  ROT();
  kload2(kf,kp0+sl_cur,0); kload2(kf,kp0+sl_cur,1);
  WAIT_BAR(2);
  s16x4 vlo[8],vhi[8]; u32x4 pw0,pw1,pw2,pw3;
  #define PKW(P,B) cvtpk_s(P[B],P[B+1])
  #define PAF(k) __builtin_bit_cast(bf16x8,pw##k)
  #define VFR(i) (bf16x8){vlo[i][0],vlo[i][1],vlo[i][2],vlo[i][3],vhi[i][0],vhi[i][1],vhi[i][2],vhi[i][3]}
  #define PIN(x) asm volatile("":"+v"(x))
  #define GAPA(MF,A0,A1,A2,A3,A4,A5,A6,A7,W0,W1,W2,W3,PW) do{ MF; sacc+=A0; sacc+=A1; sacc+=A2; sacc+=A3; sacc+=A4; sacc+=A5; sacc+=A6; sacc+=A7; PIN(sacc); W0; W1; W2; W3; PIN(PW); SBAR(); }while(0)
  #define EX(v) __builtin_amdgcn_exp2f(v)
  #define GAPB(MF,X,B) do{ MF; X[B]=EX(X[B]); X[B+1]=EX(X[B+1]); X[B+2]=EX(X[B+2]); X[B+3]=EX(X[B+3]); PIN(X); SBAR(); }while(0)
  #define VRD(i) do{ vlo[i]=vtr(vp_+(((i)>>2)*4096+((i)&3)*1024)); vhi[i]=vtr(vp_+(((i)>>2)*4096+((i)&3)*1024+512)); }while(0)
  #define KRD(G,j) do{ if(G){ kload2(kf,kp0+sl_next,j); SBAR(); } }while(0)
  #define STEP(C0,C1,P0,P1,t,GK,GV,GL) do{ SBAR(); \
    const lds_cptr vp_=vp0+sl_prev; \
    MKBIAS_A(t); \
    VRD(0); VRD(4); SBAR(); float sacc=(P0[0]+P0[1]); \
    GAPA(C0=__builtin_amdgcn_mfma_f32_32x32x16_bf16(kf[0],qr[0],nA,0,0,0), P0[2],P0[3],P0[4],P0[5],P0[6],P0[7],P0[8],P0[9],         pw0[0]=PKW(P0,0), pw0[1]=PKW(P0,2), pw0[2]=PKW(P0,4), pw0[3]=PKW(P0,6), pw0); \
    MKBIAS_B(t); VRD(1); VRD(5); SBAR(); GAPA(C1=__builtin_amdgcn_mfma_f32_32x32x16_bf16(kf[1],qr[0],nB,0,0,0), P0[10],P0[11],P0[12],P0[13],P0[14],P0[15],P1[0],P1[1], pw1[0]=PKW(P0,8), pw1[1]=PKW(P0,10), pw1[2]=PKW(P0,12),pw1[3]=PKW(P0,14), pw1); \
    VRD(2); VRD(6); SBAR(); GAPA(C0=__builtin_amdgcn_mfma_f32_32x32x16_bf16(kf[2],qr[1],C0,0,0,0),  P1[2],P1[3],P1[4],P1[5],P1[6],P1[7],P1[8],P1[9],         pw2[0]=PKW(P1,0), pw2[1]=PKW(P1,2), pw2[2]=PKW(P1,4), pw2[3]=PKW(P1,6), pw2); \
    VRD(3); VRD(7); SBAR(); GAPA(C1=__builtin_amdgcn_mfma_f32_32x32x16_bf16(kf[3],qr[1],C1,0,0,0),  P1[10],P1[11],P1[12],P1[13],P1[14],P1[15],0.f,0.f,       pw3[0]=PKW(P1,8), pw3[1]=PKW(P1,10), pw3[2]=PKW(P1,12),pw3[3]=PKW(P1,14), pw3); \
    l_reg+=sacc; \
    if(GK){DMA_K((t)+3,sl_cur);} if(GV){DMA_V((t)+1,sl_next);} \
    CMASK(C0,C1,t); \
    DECIDE(C0,C1); \
    SBAR(); \
    GAPB(o[0]=__builtin_amdgcn_mfma_f32_32x32x16_bf16(PAF(0),VFR(0),o[0],0,0,0), C0,0); \
    GAPB(o[1]=__builtin_amdgcn_mfma_f32_32x32x16_bf16(PAF(0),VFR(4),o[1],0,0,0), C0,4); \
    KRD(GL,0); GAPB(o[0]=__builtin_amdgcn_mfma_f32_32x32x16_bf16(PAF(1),VFR(1),o[0],0,0,0), C0,8); \
    KRD(GL,1); GAPB(o[1]=__builtin_amdgcn_mfma_f32_32x32x16_bf16(PAF(1),VFR(5),o[1],0,0,0), C0,12); \
    GAPB(o[0]=__builtin_amdgcn_mfma_f32_32x32x16_bf16(PAF(2),VFR(2),o[0],0,0,0), C1,0); \
    GAPB(o[1]=__builtin_amdgcn_mfma_f32_32x32x16_bf16(PAF(2),VFR(6),o[1],0,0,0), C1,4); \
    GAPB(o[0]=__builtin_amdgcn_mfma_f32_32x32x16_bf16(PAF(3),VFR(3),o[0],0,0,0), C1,8); \
    GAPB(o[1]=__builtin_amdgcn_mfma_f32_32x32x16_bf16(PAF(3),VFR(7),o[1],0,0,0), C1,12); \
    }while(0)
  int t=1;
  #undef CMASK
  #define CMASK(P0,P1,t) do{}while(0)
  for(;t+5<NT;t+=2){
    STEP(pB0,pB1,pA0,pA1,t,true,true,true);     WAIT_BAR(2); RESC(); ROT();
    STEP(pA0,pA1,pB0,pB1,t+1,true,true,true);   WAIT_BAR(2); RESC(); ROT();
  }
  #undef CMASK
  #define CMASK(P0,P1,t) do{int jb_=(t)-(NT-4); if(jb_>=0)cmask(P0,P1,jb_,qrel,hi);}while(0)
  #define ENDW(tt) do{ if((tt)+3<NT){WAIT_BAR(2);} else if((tt)+2<NT){WAIT_BAR(1);} else {WAIT_BAR(0);} }while(0)
  for(;t+1<NT;t+=2){
    STEP(pB0,pB1,pA0,pA1,t,(t+3<NT),(t+1<NT),(t+1<NT));       ENDW(t);   RESC(); ROT();
    STEP(pA0,pA1,pB0,pB1,t+1,(t+4<NT),(t+2<NT),(t+2<NT));     ENDW(t+1); RESC(); ROT();
  }
  STEP(pB0,pB1,pA0,pA1,NT-1,false,false,false); RESC();
  { float sacc=pB0[0]+pB0[1]; _Pragma("unroll") for(int r=2;r<16;++r)sacc+=pB0[r]; _Pragma("unroll") for(int r=0;r<16;++r)sacc+=pB1[r]; l_reg+=sacc;
    pw0=(u32x4){PKW(pB0,0),PKW(pB0,2),PKW(pB0,4),PKW(pB0,6)};pw1=(u32x4){PKW(pB0,8),PKW(pB0,10),PKW(pB0,12),PKW(pB0,14)};pw2=(u32x4){PKW(pB1,0),PKW(pB1,2),PKW(pB1,4),PKW(pB1,6)};pw3=(u32x4){PKW(pB1,8),PKW(pB1,10),PKW(pB1,12),PKW(pB1,14)};
    SBAR(); pv(o,vb0+sl_cur,PAF(0),PAF(1),PAF(2),PAF(3)); }
  #undef PKW
  #undef PAF
  #undef VFR
  #undef PIN
  #undef GAPA
  #undef GAPB
  #undef EX
  #undef VRD
  #undef KRD
  #undef STEP
  #undef ENDW
  {auto rr=__builtin_amdgcn_permlane32_swap(__float_as_uint(l_reg),__float_as_uint(l_reg),false,false);l_reg=__uint_as_float(rr[0])+__uint_as_float(rr[1]);}
  if(hi==0)wsf[32+r32]=l_reg;asm volatile("s_waitcnt lgkmcnt(0)":::"memory");
  float rli[16];
  #pragma unroll
  for(int r=0;r<16;++r)rli[r]=__builtin_amdgcn_rcpf(wsf[32+crow(r,hi)]);
  bf16*Ow=SLAB+(rowbase+q0+wid*QBLK)*SLABP+(2*h+c)*64;
  { bf16*stg=(bf16*)(shm+LDS_OST)+wid*2048;
    #pragma unroll
    for(int r=0;r<16;++r){const int orow=crow(r,hi);
      #pragma unroll
      for(int d0=0;d0<2;++d0)stg[orow*64+d0*32+r32]=__float2bfloat16(o[d0][r]*rli[r]);}
    asm volatile("s_waitcnt lgkmcnt(0)":::"memory");
    #pragma unroll
    for(int i=0;i<4;++i){const int row=i*8+(lane>>3),ch=lane&7; const u32x4 v=*(const u32x4*)(stg+row*64+ch*8); *(u32x4*)(Ow+(long)row*SLABP+ch*8)=v;} }
  asm volatile("s_waitcnt lgkmcnt(0)\n\ts_barrier":::"memory");
  #undef DMA_K
  #undef DMA_V
  #undef CMASK
  #undef MKBIAS_A
  #undef MKBIAS_B
  #undef DECIDE
  #undef RESC
  #undef ROT
}
constexpr int ATTN_LDS_BYTES=LDS_BYTES;
#undef SBAR
#undef WAIT_BAR
#undef MX3
}

constexpr int NWAVES = 8;
#ifndef DBG_THRL
#define DBG_THRL 8
#endif
#ifndef MK_N_LAUNCHES
#define MK_N_LAUNCHES 6
#endif
constexpr int PER_PHASE = 6;
constexpr int N_LAUNCHES = MK_N_LAUNCHES;

constexpr size_t MiB = 1u << 20;
constexpr size_t WS_CTL = 0, CTL_ZERO_BYTES = 1 * MiB;
constexpr size_t WS_WIN = 2 * MiB, WS_WKV = 16 * MiB, WS_WB = 18 * MiB, WS_WOUT = 21 * MiB, WS_WPOOL = 23 * MiB;
constexpr size_t WS_MEMB = 24 * MiB, WS_MK = 26 * MiB, WS_MVT = 27 * MiB;
constexpr size_t WS_PROJ = 32 * MiB, SEGB = 32 * MiB;
constexpr size_t WS_G = 288 * MiB;
constexpr size_t WS_END = 480 * MiB;
constexpr size_t WS_MG = WS_PROJ + 4 * SEGB;
constexpr size_t WS_OUTPRE = WS_PROJ;
constexpr size_t DO_XN = 0, DO_SLAB = 64 * MiB;
enum Seg { SEG_PU = 0, SEG_PZ = 1, SEG_Q = 2, SEG_MQ = 3, SEG_K = 4, SEG_V = 5, SEG_DZ = 6, SEG_MZ = 7 };
constexpr int CW_TMO = 0, CW_CODE = 1;
constexpr int CW_BAR = 4096;
constexpr int CW_PAIR = 16384;
static_assert((CW_PAIR + 1024 * 64) * 4 <= (int)CTL_ZERO_BYTES, "CTL words inside the memset region");

constexpr int RING_OFF = 0, RING_BYTES = 131072;
constexpr int LDSCTL_OFF = RING_BYTES, MISC_OFF = LDSCTL_OFF + 320;
constexpr int LDS_BYTES = 147456;
static_assert(MISC_OFF + 128 <= LDS_BYTES, "LDS map");

#define GAS __attribute__((address_space(1)))
#define LAS __attribute__((address_space(3)))
typedef unsigned short bf16;
typedef unsigned v4u __attribute__((ext_vector_type(4)));
typedef float f32x4 __attribute__((ext_vector_type(4)));
typedef short bf16x8 __attribute__((ext_vector_type(8)));
typedef GAS unsigned gu32;
typedef GAS unsigned long long gu64;
#define RLX_AGENT __ATOMIC_RELAXED, __HIP_MEMORY_SCOPE_AGENT
#define LDS_WAIT() asm volatile("s_waitcnt lgkmcnt(0)" ::: "memory")
#define VM_WAIT() asm volatile("s_waitcnt vmcnt(0)" ::: "memory")
__device__ __forceinline__ unsigned long long rt() { return __builtin_amdgcn_s_memrealtime(); }
__device__ __forceinline__ unsigned f2bf(float f) { unsigned u = __builtin_bit_cast(unsigned, f); return (u + 0x7fffu + ((u >> 16) & 1u)) >> 16; }
__device__ __forceinline__ unsigned pk2(float lo, float hi) { return f2bf(lo) | (f2bf(hi) << 16); }

#define XB_TMO      128
#define XB_XCNT(j)  (256  + 64 * (j))
#define XB_XSUB(j)  (1280 + 64 * (j))
#define XB_XGEN(j)  (2304 + 64 * (j))
#define XB_TOP      3328
#define XB_TOPGEN   3392
#define XCD_BAR_WORDS 3456
#define XB_SPIN_CAP (1u << 18)

__device__ __forceinline__ unsigned xb_ld(unsigned* p)              { return __hip_atomic_load(p, __ATOMIC_RELAXED, __HIP_MEMORY_SCOPE_AGENT); }
__device__ __forceinline__ unsigned xb_add(unsigned* p, unsigned v) { return __hip_atomic_fetch_add(p, v, __ATOMIC_RELAXED, __HIP_MEMORY_SCOPE_AGENT); }
__device__ __forceinline__ unsigned xb_xcc_id() { return (unsigned)__builtin_amdgcn_s_getreg((3 << 11) | 20) & 0xFu; }
#define XB_SPIN(cond, bar) do { unsigned _sp = 0; while (cond) { __builtin_amdgcn_s_sleep(1); \
    if ((++_sp & 255u) == 0u) { if (xb_ld(&(bar)[XB_TMO])) break; if (_sp > XB_SPIN_CAP) { atomicAdd(&(bar)[XB_TMO], 1u); break; } } } } while (0)

struct XcdBarrier {
    unsigned* bar; unsigned x;
    volatile LAS unsigned* st;
};

__device__ __forceinline__ XcdBarrier xcd_barrier_post(unsigned* bar, volatile LAS unsigned* st) {
    XcdBarrier b; b.bar = bar; b.x = xb_xcc_id(); b.st = st;
    if (threadIdx.x == 0) (void)xb_add(&bar[XB_XCNT(b.x)], 1u);
    return b;
}
__device__ __forceinline__ void xcd_barrier_complete(unsigned* bar, unsigned x, unsigned& nloc, unsigned& nx) {
    const unsigned G = gridDim.x * gridDim.y * gridDim.z;
    unsigned sum, cnt, mine, sp = 0u;
    for (;;) {
        sum = 0u; cnt = 0u; mine = 0u;
#pragma unroll
        for (unsigned j = 0; j < 16; ++j) { const unsigned c = xb_ld(&bar[XB_XCNT(j)]); sum += c; cnt += (c > 0u) ? 1u : 0u; mine = (j == x) ? c : mine; }
        if (sum == G) break;
        __builtin_amdgcn_s_sleep(1);
        if ((++sp & 255u) == 0u) { if (xb_ld(&bar[XB_TMO])) break; if (sp > XB_SPIN_CAP) { atomicAdd(&bar[XB_TMO], 1u); break; } }
    }
    nloc = mine > 0u ? mine : 1u; nx = cnt > 0u ? cnt : 1u;
}

__device__ __forceinline__ void xcd_barrier(const XcdBarrier& b) {
    asm volatile("s_waitcnt vmcnt(0)" ::: "memory");
    __syncthreads();
    if (threadIdx.x == 0) {
        unsigned* bar = b.bar;
        __builtin_amdgcn_s_waitcnt(0);
        unsigned nloc = b.st[0], nx = b.st[1];
        if (nloc == 0u) { xcd_barrier_complete(bar, b.x, nloc, nx); b.st[0] = nloc; b.st[1] = nx; }
        const unsigned old = xb_add(&bar[XB_XSUB(b.x)], 1u);
        const unsigned gen = old / nloc;
        if (old + 1u == (gen + 1u) * nloc) {
            __builtin_amdgcn_fence(__ATOMIC_RELEASE, "agent");
            asm volatile("s_waitcnt vmcnt(0)" ::: "memory");
            const unsigned og = xb_add(&bar[XB_TOP], 1u);
            const unsigned tg = og / nx;
            if (og + 1u == (tg + 1u) * nx) xb_add(&bar[XB_TOPGEN], 1u);
            else XB_SPIN(xb_ld(&bar[XB_TOPGEN]) == tg, bar);
            __builtin_amdgcn_fence(__ATOMIC_ACQUIRE, "agent");
            xb_add(&bar[XB_XGEN(b.x)], 1u);
            asm volatile("s_waitcnt vmcnt(0)" ::: "memory");
        } else {
            XB_SPIN(xb_ld(&bar[XB_XGEN(b.x)]) == gen, bar);
            __builtin_amdgcn_fence(__ATOMIC_ACQUIRE, "agent");
            asm volatile("s_waitcnt vmcnt(0)" ::: "memory");
        }
    }
    __syncthreads();
}


typedef short s16x4 __attribute__((ext_vector_type(4)));
typedef float f32x16 __attribute__((ext_vector_type(16)));
typedef unsigned u32x2 __attribute__((ext_vector_type(2)));
__device__ __forceinline__ float bfs(short s) { return __uint_as_float(((unsigned)(unsigned short)s) << 16); }
__device__ __forceinline__ float wave_sum(float v) {
#pragma unroll
    for (int o = 1; o < 64; o <<= 1) v += __shfl_xor(v, o);
    return v;
}
__device__ __forceinline__ void p0_transpose_item(const float* W, int K, int N, bf16* WT, LAS float* scr, int item, int lane) {
    const int nblk = N / 32, kb = item / nblk, nb = item % nblk, k0 = 64 * kb, n0 = 32 * nb;
#pragma unroll 8
    for (int i = 0; i < 32; ++i) { const int kk = 2 * i + (lane >> 5); scr[kk * 33 + (lane & 31)] = W[(size_t)(k0 + kk) * N + n0 + (lane & 31)]; }
    LDS_WAIT(); asm volatile("" ::: "memory");
    const int c = lane & 7;
#pragma unroll
    for (int j = 0; j < 4; ++j) { const int n = (lane >> 3) + 8 * j; const LAS float* s = scr + (8 * c) * 33 + n;
        v4u o; o.x = pk2(s[0 * 33], s[1 * 33]); o.y = pk2(s[2 * 33], s[3 * 33]); o.z = pk2(s[4 * 33], s[5 * 33]); o.w = pk2(s[6 * 33], s[7 * 33]);
        *(GAS v4u*)(WT + (size_t)(n0 + n) * K + k0 + 8 * c) = o; }
    LDS_WAIT(); asm volatile("" ::: "memory");
}
__device__ __forceinline__ void ln_row_to_bf16(const float* xrow, const float* g, const float* bb, bf16* orow, int lane) {
    const GAS f32x4* xr = (const GAS f32x4*)xrow + lane;
    f32x4 v[4]; float s = 0.f;
#pragma unroll
    for (int j = 0; j < 4; ++j) { v[j] = xr[64 * j]; s += (v[j].x + v[j].y) + (v[j].z + v[j].w); }
    const float mean = wave_sum(s) * (1.f / DMODEL); float s2 = 0.f;
#pragma unroll
    for (int j = 0; j < 4; ++j) { v[j] = v[j] - mean; s2 += (v[j].x * v[j].x + v[j].y * v[j].y) + (v[j].z * v[j].z + v[j].w * v[j].w); }
    const float rstd = 1.f / sqrtf(wave_sum(s2) * (1.f / DMODEL) + LN_EPS);
    GAS unsigned long long* o8 = (GAS unsigned long long*)orow + lane;
#pragma unroll
    for (int j = 0; j < 4; ++j) { const f32x4 gg = *((const f32x4*)g + lane + 64 * j), bv = *((const f32x4*)bb + lane + 64 * j); const f32x4 y = v[j] * rstd * gg + bv;
        o8[64 * j] = (unsigned long long)pk2(y.x, y.y) | ((unsigned long long)pk2(y.z, y.w) << 32); }
}
__device__ __forceinline__ void cvt_row_to_bf16(const float* xrow, bf16* orow, int lane) {
    const GAS f32x4* xr = (const GAS f32x4*)xrow + lane; GAS unsigned long long* o8 = (GAS unsigned long long*)orow + lane;
#pragma unroll
    for (int j = 0; j < 4; ++j) { const f32x4 y = xr[64 * j]; o8[64 * j] = (unsigned long long)pk2(y.x, y.y) | ((unsigned long long)pk2(y.z, y.w) << 32); }
}
__device__ __forceinline__ void final_row(const float* xrow, const bf16* yrow, const float* gi, const float* bi, const float* go, const float* bo, float* orow, int lane) {
    const GAS f32x4* xr = (const GAS f32x4*)xrow + lane;
    f32x4 v[4]; float s = 0.f;
#pragma unroll
    for (int j = 0; j < 4; ++j) { v[j] = xr[64 * j]; s += (v[j].x + v[j].y) + (v[j].z + v[j].w); }
    u32x2 yv[4];
#pragma unroll
    for (int j = 0; j < 4; ++j) yv[j] = *((const GAS u32x2*)yrow + lane + 64 * j);
    const float mean = wave_sum(s) * (1.f / DMODEL); float s2 = 0.f;
#pragma unroll
    for (int j = 0; j < 4; ++j) { v[j] = v[j] - mean; s2 += (v[j].x * v[j].x + v[j].y * v[j].y) + (v[j].z * v[j].z + v[j].w * v[j].w); }
    const float rstd = 1.f / sqrtf(wave_sum(s2) * (1.f / DMODEL) + LN_EPS);
    float t = 0.f;
#pragma unroll
    for (int j = 0; j < 4; ++j) { const f32x4 gg = *((const f32x4*)gi + lane + 64 * j), bv = *((const f32x4*)bi + lane + 64 * j);
        f32x4 h = v[j] * rstd * gg + bv; const f32x4 y = (f32x4){pg8::bf_lo(yv[j].x), pg8::bf_hi(yv[j].x), pg8::bf_lo(yv[j].y), pg8::bf_hi(yv[j].y)};
#ifdef DBG_OUTSCALE
        h = h * DN_ALPHA + y * DBG_OUTSCALE; v[j] = h;
#else
        h = h * DN_ALPHA + y; v[j] = h;
#endif
        t += (h.x + h.y) + (h.z + h.w); }
    const float mean2 = wave_sum(t) * (1.f / DMODEL); float t2 = 0.f;
#pragma unroll
    for (int j = 0; j < 4; ++j) { v[j] = v[j] - mean2; t2 += (v[j].x * v[j].x + v[j].y * v[j].y) + (v[j].z * v[j].z + v[j].w * v[j].w); }
    const float rstd2 = 1.f / sqrtf(wave_sum(t2) * (1.f / DMODEL) + LN_EPS);
    GAS f32x4* o = (GAS f32x4*)orow + lane;
#pragma unroll
    for (int j = 0; j < 4; ++j) { const f32x4 gg = *((const f32x4*)go + lane + 64 * j), bv = *((const f32x4*)bo + lane + 64 * j); o[64 * j] = v[j] * rstd2 * gg + bv; }
}

__device__ __forceinline__ void mem_attn_wave(int b, int mh, long row0, bf16* MQ, const bf16* MK, const bf16* MVT, const bf16* MZ, int lane) {
    const int r32 = lane & 31, hi = lane >> 5;
    bf16* qrow = MQ + (row0 + r32) * 512 + mh * 128;
    bf16x8 qr[8];
#pragma unroll
    for (int d0 = 0; d0 < 8; ++d0) qr[d0] = *(const bf16x8*)(qrow + 16 * d0 + 8 * hi);
    const bf16* kbase = MK + ((long)b * MEMLEN + r32) * 512 + mh * 128 + 8 * hi;
    float m = -INFINITY;
#pragma nounroll
    for (int n = 0; n < 8; ++n) { f32x16 acc = f32x16{};
#pragma unroll
        for (int d0 = 0; d0 < 8; ++d0) { const bf16x8 kf = *(const bf16x8*)(kbase + (long)n * 32 * 512 + 16 * d0); acc = __builtin_amdgcn_mfma_f32_32x32x16_bf16(kf, qr[d0], acc, 0, 0, 0); }
#pragma unroll
        for (int r = 0; r < 16; ++r) m = fmaxf(m, acc[r]); }
    { auto rr = __builtin_amdgcn_permlane32_swap(__float_as_uint(m), __float_as_uint(m), false, false); m = fmaxf(__uint_as_float(rr[0]), __uint_as_float(rr[1])); }
    float l = 0.f; f32x16 o[4];
#pragma unroll
    for (int dblk = 0; dblk < 4; ++dblk) o[dblk] = f32x16{};
    const bf16* vbase = MVT + ((long)mh * 128 + r32) * 1024 + b * MEMLEN + 4 * hi;
#pragma nounroll
    for (int n = 0; n < 8; ++n) { f32x16 acc = f32x16{};
#pragma unroll
        for (int d0 = 0; d0 < 8; ++d0) { const bf16x8 kf = *(const bf16x8*)(kbase + (long)n * 32 * 512 + 16 * d0); acc = __builtin_amdgcn_mfma_f32_32x32x16_bf16(kf, qr[d0], acc, 0, 0, 0); }
#pragma unroll
        for (int r = 0; r < 16; ++r) { const float e = __builtin_amdgcn_exp2f(acc[r] - m); acc[r] = e; l += e; }
        v4u pw[2];
#pragma unroll
        for (int s = 0; s < 2; ++s) { pw[s].x = pk2(acc[8 * s + 0], acc[8 * s + 1]); pw[s].y = pk2(acc[8 * s + 2], acc[8 * s + 3]); pw[s].z = pk2(acc[8 * s + 4], acc[8 * s + 5]); pw[s].w = pk2(acc[8 * s + 6], acc[8 * s + 7]); }
#pragma unroll
        for (int dblk = 0; dblk < 4; ++dblk)
#pragma unroll
            for (int s = 0; s < 2; ++s) { const bf16* vp = vbase + (long)dblk * 32 * 1024 + 32 * n + 16 * s; const s16x4 lo = *(const s16x4*)vp, h4 = *(const s16x4*)(vp + 8);
                const bf16x8 vf = (bf16x8){lo[0], lo[1], lo[2], lo[3], h4[0], h4[1], h4[2], h4[3]};
                o[dblk] = __builtin_amdgcn_mfma_f32_32x32x16_bf16(vf, __builtin_bit_cast(bf16x8, pw[s]), o[dblk], 0, 0, 0); } }
    { auto rr = __builtin_amdgcn_permlane32_swap(__float_as_uint(l), __float_as_uint(l), false, false); l = __uint_as_float(rr[0]) + __uint_as_float(rr[1]); }
    const float rl = 1.0f / l;
    const bf16* zrow = MZ + (row0 + r32) * 512 + mh * 128;
#pragma unroll
    for (int dblk = 0; dblk < 4; ++dblk)
#pragma unroll
        for (int g = 0; g < 4; ++g) { const int d = 32 * dblk + 8 * g + 4 * hi; const u32x2 z = *(const u32x2*)(zrow + d);
            u32x2 w; w.x = pk2(o[dblk][4 * g + 0] * rl * pg8::bf_lo(z.x), o[dblk][4 * g + 1] * rl * pg8::bf_hi(z.x)); w.y = pk2(o[dblk][4 * g + 2] * rl * pg8::bf_lo(z.y), o[dblk][4 * g + 3] * rl * pg8::bf_hi(z.y));
            *(u32x2*)(qrow + d) = w; }
}

__device__ __forceinline__ void pool_wave(int g, long tok0, const bf16* PU, bf16* PZ, const bf16* WPT, const float* pool_scale, int lane) {
    const int r32 = lane & 31, hi = lane >> 5; const long tok = tok0 + r32; const int tseq = (int)(tok & (SEQ - 1)); const int w = 2 << g;
    const int cnt = (tseq + 1) < w ? (tseq + 1) : w; const float rc = 1.0f / (float)cnt;
    bf16x8 bfr[8];
#pragma unroll
    for (int s = 0; s < 8; ++s) { const int ch0 = g * 128 + 16 * s + 8 * hi; float a[8];
#pragma unroll
        for (int j = 0; j < 8; ++j) a[j] = 0.f;
        for (int i = 0; i < w; ++i) { const int back = i < cnt ? i : 0; const float wt = i < cnt ? 1.f : 0.f; const bf16x8 u = *(const bf16x8*)(PU + (tok - back) * 512 + ch0);
#pragma unroll
            for (int j = 0; j < 8; ++j) a[j] += wt * bfs(u[j]); }
        const bf16x8 u0 = *(const bf16x8*)(PU + tok * 512 + ch0);
        v4u pk; pk.x = pk2(a[0] * rc - bfs(u0[0]), a[1] * rc - bfs(u0[1])); pk.y = pk2(a[2] * rc - bfs(u0[2]), a[3] * rc - bfs(u0[3]));
        pk.z = pk2(a[4] * rc - bfs(u0[4]), a[5] * rc - bfs(u0[5])); pk.w = pk2(a[6] * rc - bfs(u0[6]), a[7] * rc - bfs(u0[7]));
        bfr[s] = __builtin_bit_cast(bf16x8, pk); }
    const bf16* wbase = WPT + ((long)g * 128 + r32) * 128 + 8 * hi;
    bf16* zrow = PZ + tok * 512 + g * 128;
#pragma unroll
    for (int ob = 0; ob < 4; ++ob) { f32x16 acc = f32x16{};
#pragma unroll
        for (int s = 0; s < 8; ++s) { const bf16x8 af = *(const bf16x8*)(wbase + (long)ob * 32 * 128 + 16 * s); acc = __builtin_amdgcn_mfma_f32_32x32x16_bf16(af, bfr[s], acc, 0, 0, 0); }
#pragma unroll
        for (int q = 0; q < 4; ++q) { const int ch = 32 * ob + 8 * q + 4 * hi; const u32x2 z = *(const u32x2*)(zrow + ch); const f32x4 ps = *(const f32x4*)(pool_scale + g * 128 + ch);
            u32x2 wv; wv.x = pk2(acc[4 * q + 0] * ps[0] * pg8::bf_lo(z.x), acc[4 * q + 1] * ps[1] * pg8::bf_hi(z.x)); wv.y = pk2(acc[4 * q + 2] * ps[2] * pg8::bf_lo(z.y), acc[4 * q + 3] * ps[3] * pg8::bf_hi(z.y));
#ifdef DBG_ZGROUP
            if ((DBG_ZGROUP >> g) & 1) wv = (u32x2){0u, 0u};
#endif
            *(u32x2*)(zrow + ch) = wv; } }
}

__device__ __forceinline__ void combine_pair(int b, int h, int qb, const bf16* SLAB, const bf16* DZ, bf16* OD, const float* gnorm, float lam, int wave, int lane) {
    const long rowbase = (long)b * SEQ + qb * 256 + wave * 32; const int ch = lane & 7;
    const f32x4 g0 = *(const f32x4*)(gnorm + 8 * ch), g1 = *(const f32x4*)(gnorm + 8 * ch + 4);
#pragma unroll
    for (int i = 0; i < 4; ++i) { const long row = rowbase + i * 8 + (lane >> 3);
        const v4u a = *(const v4u*)(SLAB + row * 1024 + (2 * h) * 64 + 8 * ch), c = *(const v4u*)(SLAB + row * 1024 + (2 * h + 1) * 64 + 8 * ch), z = *(const v4u*)(DZ + row * 512 + h * 64 + 8 * ch);
        float d[8];
        d[0] = pg8::bf_lo(a.x) - lam * pg8::bf_lo(c.x); d[1] = pg8::bf_hi(a.x) - lam * pg8::bf_hi(c.x); d[2] = pg8::bf_lo(a.y) - lam * pg8::bf_lo(c.y); d[3] = pg8::bf_hi(a.y) - lam * pg8::bf_hi(c.y);
        d[4] = pg8::bf_lo(a.z) - lam * pg8::bf_lo(c.z); d[5] = pg8::bf_hi(a.z) - lam * pg8::bf_hi(c.z); d[6] = pg8::bf_lo(a.w) - lam * pg8::bf_lo(c.w); d[7] = pg8::bf_hi(a.w) - lam * pg8::bf_hi(c.w);
        float ss = 0.f;
#pragma unroll
        for (int j = 0; j < 8; ++j) ss += d[j] * d[j];
        ss += __shfl_xor(ss, 1); ss += __shfl_xor(ss, 2); ss += __shfl_xor(ss, 4);
        const float rs = (1.0f - LAM_INIT) / sqrtf(ss * (1.0f / 64.0f) + RMS_EPS);
        v4u o; o.x = pk2(d[0] * rs * g0[0] * pg8::bf_lo(z.x), d[1] * rs * g0[1] * pg8::bf_hi(z.x)); o.y = pk2(d[2] * rs * g0[2] * pg8::bf_lo(z.y), d[3] * rs * g0[3] * pg8::bf_hi(z.y));
        o.z = pk2(d[4] * rs * g1[0] * pg8::bf_lo(z.z), d[5] * rs * g1[1] * pg8::bf_hi(z.z)); o.w = pk2(d[6] * rs * g1[2] * pg8::bf_lo(z.w), d[7] * rs * g1[3] * pg8::bf_hi(z.w));
#ifdef DBG_ZHEAD
        if ((DBG_ZHEAD >> h) & 1) o = (v4u){0u, 0u, 0u, 0u};
#endif
        *(v4u*)(OD + row * 512 + h * 64 + 8 * ch) = o; }
}

struct Args { const float* in[18]; float* out; unsigned char* ws; int ph_lo, ph_hi, li, pad; };
enum In { I_X = 0, I_MEM, I_LNG, I_LNB, I_WIN, I_BGATE, I_POOLW, I_POOLS, I_LQ1, I_LK1, I_LQ2, I_LK2, I_DNG, I_WKV, I_WB, I_WOUT, I_LOG, I_LOB };
__global__ void __launch_bounds__(NWAVES * 64, 2) hybrid_fwd(Args args) {
    extern __shared__ __attribute__((aligned(16))) unsigned char lds[];
    LAS unsigned char* const ldsl = (LAS unsigned char*)lds;
    volatile LAS unsigned* const MISC = (volatile LAS unsigned*)(ldsl + MISC_OFF);
    const int tid = threadIdx.x, lane = tid & 63, wave = __builtin_amdgcn_readfirstlane(tid >> 6);
    const int G = gridDim.x; const int bx = blockIdx.x; const int vcu = (G % 8 == 0) ? (bx % 8) * (G / 8) + bx / 8 : bx;
    unsigned char* const ws = args.ws;
    gu32* const ctl = (gu32*)(ws + WS_CTL);
    const float* const x = args.in[I_X];
    bf16* const Win_t = (bf16*)(ws + WS_WIN); bf16* const Wkv_t = (bf16*)(ws + WS_WKV); bf16* const Wb_t = (bf16*)(ws + WS_WB); bf16* const Wout_t = (bf16*)(ws + WS_WOUT); bf16* const Wpool_t = (bf16*)(ws + WS_WPOOL);
    bf16* const MEMB = (bf16*)(ws + WS_MEMB); bf16* const MK = (bf16*)(ws + WS_MK); bf16* const MVT = (bf16*)(ws + WS_MVT);
    bf16* const PROJ = (bf16*)(ws + WS_PROJ); bf16* const GATE = (bf16*)(ws + WS_G); bf16* const MG = (bf16*)(ws + WS_MG); bf16* const OUTPRE = (bf16*)(ws + WS_OUTPRE);
    bf16* const XN = (bf16*)((unsigned char*)args.out + DO_XN); bf16* const SLAB = (bf16*)((unsigned char*)args.out + DO_SLAB);
#define SEGP(s) (PROJ + (size_t)(s) * (size_t)MROWS * 512)
    for (int u = tid; u < (LDS_BYTES - LDSCTL_OFF) / 4; u += NWAVES * 64) ((LAS unsigned*)(ldsl + LDSCTL_OFF))[u] = 0u;
    __syncthreads();
    XcdBarrier bar; bar.bar = (unsigned*)(ctl + CW_BAR); bar.x = 0; bar.st = nullptr;
    if (N_LAUNCHES != PER_PHASE) bar = xcd_barrier_post((unsigned*)(ctl + CW_BAR), MISC + 8);
#define GRID_BAR() do { if (N_LAUNCHES == PER_PHASE) { if (tid == 0) __hip_atomic_store(ctl + CW_TMO, 0xBADBA0u, RLX_AGENT); } else { xcd_barrier(bar); } } while (0)
    const int lo = args.ph_lo, hi = args.ph_hi;
#define IN(k) (lo <= (k) && (k) < hi)
#define BOTH(k) (IN(k) && IN((k) + 1))
    const int gw = vcu * NWAVES + wave, NGW = G * NWAVES;

    if (IN(0)) {
        LAS float* scr = (LAS float*)(ldsl + RING_OFF + wave * 16384);
        constexpr int I_IN = (DMODEL / 64) * (NIN / 32), I_KV = (DMODEL / 64) * (1024 / 32), I_B = (BW / 64) * (DMODEL / 32), I_OUT = (DMODEL / 64) * (DMODEL / 32), I_PW = (128 / 64) * (128 / 32);
        constexpr int NITEMS = I_IN + I_KV + 3 * I_B + I_OUT + 4 * I_PW;
        for (int it = gw; it < NITEMS; it += NGW) {
            int r = it;
            if (r < I_IN) { p0_transpose_item(args.in[I_WIN], DMODEL, NIN, Win_t, scr, r, lane); continue; } r -= I_IN;
            if (r < I_KV) { p0_transpose_item(args.in[I_WKV], DMODEL, 1024, Wkv_t, scr, r, lane); continue; } r -= I_KV;
            if (r < 3 * I_B) { const int n = r / I_B; p0_transpose_item(args.in[I_WB] + (size_t)n * BW * DMODEL, BW, DMODEL, Wb_t + (size_t)n * DMODEL * BW, scr, r - n * I_B, lane); continue; } r -= 3 * I_B;
            if (r < I_OUT) { p0_transpose_item(args.in[I_WOUT], DMODEL, DMODEL, Wout_t, scr, r, lane); continue; } r -= I_OUT;
            { const int n = r / I_PW; p0_transpose_item(args.in[I_POOLW] + (size_t)n * 128 * 128, 128, 128, Wpool_t + (size_t)n * 128 * 128, scr, r - n * I_PW, lane); }
        }
        for (int m = gw; m < MROWS; m += NGW) ln_row_to_bf16(x + (size_t)m * DMODEL, args.in[I_LNG], args.in[I_LNB], XN + (size_t)m * DMODEL, lane);
        for (int m = gw; m < BATCH * MEMLEN; m += NGW) cvt_row_to_bf16(args.in[I_MEM] + (size_t)m * DMODEL, MEMB + (size_t)m * DMODEL, lane);
        if (BOTH(0)) GRID_BAR();
    }

    if (IN(1)) {
        { pg8::Gemm g{XN, Win_t, 0, 0, MROWS, NIN, DMODEL}; pg8::StaticOrder S; S.init(MROWS, NIN, G, bx);
          pg8::EpiProj E{PROJ, GATE, args.in[I_BGATE], MROWS};
          pg8::gemm_phase<pg8::EpiProj, pg8::StaticOrder, PG8_ALIGN, PG8_SP2>(ldsl + RING_OFF, g, S, E); }
        { pg8::Gemm g{MEMB, Wkv_t, 0, 0, BATCH * MEMLEN, 512, DMODEL}; pg8::StaticOrder S; S.init(BATCH * MEMLEN, 512, G, (bx + 8) % G);
          pg8::EpiBf16 E{MK, 512};
          pg8::gemm_phase<pg8::EpiBf16, pg8::StaticOrder, PG8_ALIGN, PG8_SP2>(ldsl + RING_OFF, g, S, E); }
        { const bf16* Wv = Wkv_t + (size_t)512 * DMODEL; pg8::Gemm g{Wv, MEMB, 0, 0, 512, BATCH * MEMLEN, DMODEL}; pg8::StaticOrder S; S.init(512, BATCH * MEMLEN, G, (bx + 16) % G);
          pg8::EpiBf16 E{MVT, BATCH * MEMLEN};
          pg8::gemm_phase<pg8::EpiBf16, pg8::StaticOrder, PG8_ALIGN, PG8_SP2>(ldsl + RING_OFF, g, S, E); }
        if (BOTH(1)) GRID_BAR();
    }

    if (IN(2)) {
        float lam;
        { float a = 0.f, c = 0.f; if (lane < 32) { a = args.in[I_LQ1][lane] * args.in[I_LK1][lane]; c = args.in[I_LQ2][lane] * args.in[I_LK2][lane]; }
          a = wave_sum(a); c = wave_sum(c); lam = expf(a) - expf(c) + LAM_INIT; }
        if (G == 256) {
            const int stream = vcu >> 2, s = vcu & 3; const int b = stream >> 4, h = (stream >> 1) & 7, c = stream & 1;
            const float slope2 = __uint_as_float(__builtin_amdgcn_readfirstlane(__float_as_uint(exp2f(-(float)(h + 1)) * LOG2E)));
            for (int i = 0; i < 8; ++i) { const int qb = (i & 1) ? (8 * (i >> 1) + 7 - s) : (8 * (i >> 1) + s);
#ifndef NO_ATT
                dattn::attn_unit<DBG_THRL>(b, h, c, qb, (const dattn::bf16*)SEGP(SEG_Q), (const dattn::bf16*)SEGP(SEG_K), (const dattn::bf16*)SEGP(SEG_V), (dattn::bf16*)SLAB, (char*)lds + RING_OFF, slope2);
#endif
                asm volatile("s_waitcnt vmcnt(0)" ::: "memory"); __syncthreads();
                if (tid == 0) { __builtin_amdgcn_fence(__ATOMIC_RELEASE, "agent"); asm volatile("s_waitcnt vmcnt(0)" ::: "memory");
                    const unsigned tk = __hip_atomic_fetch_add((unsigned*)(ctl + CW_PAIR + 64 * ((b * NHEAD + h) * 32 + qb)), 1u, __ATOMIC_RELAXED, __HIP_MEMORY_SCOPE_AGENT);
                    if (tk == 1u) { __builtin_amdgcn_fence(__ATOMIC_ACQUIRE, "agent"); asm volatile("s_waitcnt vmcnt(0)" ::: "memory"); }
                    MISC[4] = tk; }
                __syncthreads();
                if (MISC[4] == 1u) combine_pair(b, h, qb, SLAB, SEGP(SEG_DZ), SEGP(SEG_Q), args.in[I_DNG], lam, wave, lane);
                __syncthreads();
            }
            int lane2 = lane; asm volatile("" : "+v"(lane2));
            for (int j = 0; j < 2; ++j) { const int item = 2 * vcu + j, bm = item >> 5, qblk = item & 31; const int b2 = bm >> 2, mh = bm & 3;
#ifndef NO_MEM
                mem_attn_wave(b2, mh, (long)b2 * SEQ + qblk * 256 + wave * 32, SEGP(SEG_MQ), MK, MVT, SEGP(SEG_MZ), lane2);
#endif
            }
            { const long tok0 = (long)(gw >> 1) * 32; const int ga = (gw & 1) ? 1 : 0, gb = (gw & 1) ? 2 : 3;
#ifndef NO_POOL
              pool_wave(ga, tok0, SEGP(SEG_PU), SEGP(SEG_PZ), Wpool_t, args.in[I_POOLS], lane2);
              pool_wave(gb, tok0, SEGP(SEG_PU), SEGP(SEG_PZ), Wpool_t, args.in[I_POOLS], lane2);
#endif
            }
        } else if (bx == 0 && tid == 0) { __hip_atomic_store(ctl + CW_TMO, 0x7f0u, RLX_AGENT); }
        if (BOTH(2)) GRID_BAR();
    }

    if (IN(3)) {
        pg8::Gemm g{SEGP(SEG_PZ), Wb_t, (size_t)MROWS * 512, (size_t)DMODEL * BW, MROWS, DMODEL, BW}; pg8::StaticOrderZ<3> S; S.init(MROWS, DMODEL, G, bx);
        pg8::EpiMerge E{GATE, MG};
        pg8::gemm_phase<pg8::EpiMerge, pg8::StaticOrderZ<3>, PG8_ALIGN, PG8_SP2>(ldsl + RING_OFF, g, S, E);
        if (BOTH(3)) GRID_BAR();
    }

    if (IN(4)) {
        pg8::Gemm g{MG, Wout_t, 0, 0, MROWS, DMODEL, DMODEL}; pg8::StaticOrder S; S.init(MROWS, DMODEL, G, bx);
        pg8::EpiBf16 E{OUTPRE, DMODEL};
        pg8::gemm_phase<pg8::EpiBf16, pg8::StaticOrder, PG8_ALIGN, PG8_SP2>(ldsl + RING_OFF, g, S, E);
        if (BOTH(4)) GRID_BAR();
    }

    if (IN(5)) {
        const bool bad = (__hip_atomic_load(ctl + CW_TMO, RLX_AGENT) != 0u) || (__hip_atomic_load((gu32*)((unsigned*)(ctl + CW_BAR) + XB_TMO), RLX_AGENT) != 0u);
        for (int m = gw; m < MROWS; m += NGW) {
            final_row(x + (size_t)m * DMODEL, OUTPRE + (size_t)m * DMODEL, args.in[I_LNG], args.in[I_LNB], args.in[I_LOG], args.in[I_LOB], args.out + (size_t)m * DMODEL, lane);
            if (bad && N_LAUNCHES != PER_PHASE) { const float q = __builtin_nanf(""); GAS f32x4* o = (GAS f32x4*)(args.out + (size_t)m * DMODEL) + lane;
#pragma unroll
                for (int j = 0; j < 4; ++j) o[64 * j] = (f32x4){q, q, q, q}; }
        }
    }
#undef IN
#undef BOTH
#undef SEGP
}

extern "C" void kernel_launch(void* const* d_in, const int* in_sizes, int n_in, void* d_out, int out_size, void* d_ws, size_t ws_size, hipStream_t stream) {
    static int grid = 0;
    if (grid == 0) {
        if (n_in != 18 || in_sizes[0] != MROWS * DMODEL || out_size != MROWS * DMODEL || ws_size < WS_END) { fprintf(stderr, "kernel_launch: shape/workspace mismatch (n_in %d, in0 %d, out %d, ws %zu); nothing launched\n", n_in, n_in > 0 ? in_sizes[0] : -1, out_size, ws_size); grid = -1; return; }
        int dev = 0, cus = 0, per_cu = 0;
        if (hipGetDevice(&dev) != hipSuccess || hipDeviceGetAttribute(&cus, hipDeviceAttributeMultiprocessorCount, dev) != hipSuccess) { fprintf(stderr, "kernel_launch: device query failed\n"); grid = -1; return; }
        if (hipFuncSetAttribute((const void*)hybrid_fwd, hipFuncAttributeMaxDynamicSharedMemorySize, LDS_BYTES) != hipSuccess) { fprintf(stderr, "kernel_launch: hipFuncSetAttribute failed\n"); grid = -1; return; }
        if (hipOccupancyMaxActiveBlocksPerMultiprocessor(&per_cu, (const void*)hybrid_fwd, NWAVES * 64, LDS_BYTES) != hipSuccess || per_cu < 1) { fprintf(stderr, "kernel_launch: occupancy query reports %d workgroups per CU\n", per_cu); per_cu = 1; }
        (void)hipGetLastError();
        grid = cus;
        if (grid != 256) fprintf(stderr, "kernel_launch: %d CUs; the mixer phase expects 256\n", grid);
    }
    if (grid < 0) return;
    if (hipMemsetAsync((char*)d_ws + WS_CTL, 0, CTL_ZERO_BYTES, stream) != hipSuccess) { fprintf(stderr, "kernel_launch: hipMemsetAsync failed\n"); return; }
    Args a{};
    for (int i = 0; i < 18; ++i) a.in[i] = (const float*)d_in[i];
    a.out = (float*)d_out; a.ws = (unsigned char*)d_ws;
    for (int li = 0; li < N_LAUNCHES; ++li) {
        a.ph_lo = (N_LAUNCHES == PER_PHASE) ? li : 0; a.ph_hi = (N_LAUNCHES == PER_PHASE) ? li + 1 : PER_PHASE; a.li = li;
#ifdef DBG_MEMSET
        if (N_LAUNCHES == PER_PHASE && li == 3) (void)hipMemsetAsync((char*)d_ws + WS_MG, 0, 64 * MiB, stream);
        if (N_LAUNCHES == PER_PHASE && li == 4) (void)hipMemsetAsync((char*)d_ws + WS_OUTPRE, 0, 64 * MiB, stream);
#endif
        hipLaunchKernelGGL(hybrid_fwd, dim3(grid), dim3(NWAVES * 64), LDS_BYTES, stream, a);
        const hipError_t le = hipPeekAtLastError();
        if (le != hipSuccess) { fprintf(stderr, "kernel_launch: launch %d failed: %s\n", li, hipGetErrorName(le)); break; }
    }
}
```
